# Optimizing an MI355X kernel written in HIP

```python
import jax, jax.numpy as jnp
from jax import lax
import numpy as np

D_MODEL = 1024
BATCH = 4
SEQ = 4096
DEPTH = 1
DEC_BATCH = 16
DEC_SEQ = 32
PAST_LEN = 1024

CHUNK = 64
WINDOW = 128
WIN_CHUNKS = WINDOW // CHUNK
BAND = (WIN_CHUNKS + 1) * CHUNK
D_MIX = D_MODEL
HEAD_DIM = 64
N_HEADS = 8
N_KV_HEADS = 2
GQA_GROUP = N_HEADS // N_KV_HEADS
D_ATTN = N_HEADS * HEAD_DIM
D_KV = N_KV_HEADS * HEAD_DIM
D_CONV = D_MIX - D_ATTN
CONV_WIDTH = 3
D_FF = 2816
D_PLE = 256
RMS_EPS = 1e-6
ATTN_SCALE = HEAD_DIM ** -0.5
Q_END = D_ATTN
K_END = Q_END + D_KV
V_END = K_END + D_KV
B_END = V_END + D_CONV
C_END = B_END + D_CONV
D_IN = C_END + D_CONV

kernel_name = 'hymba_swa_sink_shortconv_macaron_ple_step'


def rms_norm(x, g):
    x32 = x.astype(jnp.float32)
    y = x32 * lax.rsqrt(jnp.mean(x32 * x32, axis=-1, keepdims=True) + RMS_EPS)
    return (y * g.astype(jnp.float32)).astype(x.dtype)


def swiglu_ffn(x, w_gate_up, w_down):
    g, u = jnp.split(x @ w_gate_up, 2, axis=-1)
    return (jax.nn.silu(g) * u) @ w_down


def sink_softmax(scores, sinks):
    s = sinks.astype(jnp.float32).reshape(N_KV_HEADS, GQA_GROUP)[:, :, None, None]
    m = jnp.maximum(jnp.max(scores, axis=-1, keepdims=True), s)
    e = jnp.exp(scores - m)
    return e / (jnp.sum(e, axis=-1, keepdims=True) + jnp.exp(s - m))


def window_attention_prompt(q, k, v, sinks):
    b, s = q.shape[:2]
    n_c = s // CHUNK
    qc = q.reshape(b, n_c, CHUNK, N_KV_HEADS, GQA_GROUP, HEAD_DIM)

    def band(t):
        tc = t.reshape(b, n_c, CHUNK, N_KV_HEADS, HEAD_DIM)
        tp = jnp.pad(tc, ((0, 0), (WIN_CHUNKS, 0), (0, 0), (0, 0), (0, 0)))
        return jnp.concatenate([tp[:, j:j + n_c] for j in range(WIN_CHUNKS + 1)], axis=2)

    kb, vb = band(k), band(v)
    key_chunk = jnp.arange(n_c)[:, None] - WIN_CHUNKS + (jnp.arange(BAND) // CHUNK)[None, :]
    valid = (key_chunk >= 0)[None, :, None, None, None, :]
    scores = jnp.einsum('bcqkgd,bcskd->bckgqs', qc, kb, preferred_element_type=jnp.float32) * ATTN_SCALE
    scores = jnp.where(valid, scores, -jnp.inf)
    probs = sink_softmax(scores, sinks).astype(vb.dtype)
    out = jnp.einsum('bckgqs,bcskd->bcqkgd', probs, vb)
    return out.reshape(b, s, D_ATTN), k[:, -WINDOW:], v[:, -WINDOW:]


def window_attention_sample(q, k, v, sinks, k_cache, v_cache):
    b, t = q.shape[:2]
    qg = q.reshape(b, t, N_KV_HEADS, GQA_GROUP, HEAD_DIM)
    kk = jnp.concatenate([k_cache.astype(k.dtype), k], axis=1)
    vv = jnp.concatenate([v_cache.astype(v.dtype), v], axis=1)
    scores = jnp.einsum('bqkgd,bskd->bkgqs', qg, kk, preferred_element_type=jnp.float32) * ATTN_SCALE
    probs = sink_softmax(scores, sinks).astype(vv.dtype)
    out = jnp.einsum('bkgqs,bskd->bqkgd', probs, vv)
    return out.reshape(b, t, D_ATTN), kk[:, -WINDOW:], vv[:, -WINDOW:]


def gated_short_conv(b_gate, c_gate, xv, conv_prev, conv_w):
    cin = c_gate * xv
    padded = jnp.concatenate([conv_prev.astype(cin.dtype), cin], axis=1)
    t = cin.shape[1]
    conv = padded[:, 0:t] * conv_w[0]
    for j in range(1, CONV_WIDTH):
        conv = conv + padded[:, j:j + t] * conv_w[j]
    return b_gate * conv, padded[:, -(CONV_WIDTH - 1):]


def encoder_layer(x, p, attend, conv_prev,
                  norm_ffn1_pre, w_ffn1_gate_up, w_ffn1_down, norm_ffn1_post,
                  norm_mix_pre, w_in, conv_w, attn_sinks, norm_attn_out, norm_conv_out, w_out, norm_mix_post,
                  norm_ffn2_pre, w_ffn2_gate_up, w_ffn2_down, norm_ffn2_post,
                  norm_ple_pre, w_ple_gate, w_ple_proj, norm_ple_post):
    r = x + 0.5 * rms_norm(swiglu_ffn(rms_norm(x, norm_ffn1_pre), w_ffn1_gate_up, w_ffn1_down), norm_ffn1_post)
    z = rms_norm(r, norm_mix_pre) @ w_in
    b, t = z.shape[:2]
    q = z[..., :Q_END].reshape(b, t, N_HEADS, HEAD_DIM)
    k = z[..., Q_END:K_END].reshape(b, t, N_KV_HEADS, HEAD_DIM)
    v = z[..., K_END:V_END].reshape(b, t, N_KV_HEADS, HEAD_DIM)
    attn_out, k_state, v_state = attend(q, k, v, attn_sinks)
    conv_out, conv_state = gated_short_conv(z[..., V_END:B_END], z[..., B_END:C_END], z[..., C_END:], conv_prev, conv_w)
    mixed = jnp.concatenate([rms_norm(attn_out, norm_attn_out), rms_norm(conv_out, norm_conv_out)], axis=-1) @ w_out
    r = r + rms_norm(mixed, norm_mix_post)
    r = r + 0.5 * rms_norm(swiglu_ffn(rms_norm(r, norm_ffn2_pre), w_ffn2_gate_up, w_ffn2_down), norm_ffn2_post)
    gate = jax.nn.sigmoid(rms_norm(r, norm_ple_pre) @ w_ple_gate)
    r = r + rms_norm(gate * (p @ w_ple_proj), norm_ple_post)
    return r, k_state, v_state, conv_state


def setup_inputs(seed: int = 0) -> dict:
    key = jax.random.key(seed)
    ks = iter(jax.random.split(key, 40))
    nrm = lambda shape, scale=1.0: jax.random.normal(next(ks), shape, jnp.float32) * scale
    gain = lambda dim: 1.0 + nrm((DEPTH, dim), 0.01)
    return {
        'x_prompt': nrm((BATCH, SEQ, D_MODEL)),
        'x_sample': nrm((DEC_BATCH, DEC_SEQ, D_MODEL)),
        'cache_attn_k': nrm((DEPTH, DEC_BATCH, WINDOW, N_KV_HEADS, HEAD_DIM)),
        'cache_attn_v': nrm((DEPTH, DEC_BATCH, WINDOW, N_KV_HEADS, HEAD_DIM)),
        'cache_conv': nrm((DEPTH, DEC_BATCH, CONV_WIDTH - 1, D_CONV)),
        'p_prompt': nrm((DEPTH, BATCH, SEQ, D_PLE)),
        'p_sample': nrm((DEPTH, DEC_BATCH, DEC_SEQ, D_PLE)),
        'norm_ffn1_pre': gain(D_MODEL),
        'w_ffn1_gate_up': nrm((DEPTH, D_MODEL, 2 * D_FF), D_MODEL ** -0.5),
        'w_ffn1_down': nrm((DEPTH, D_FF, D_MODEL), D_FF ** -0.5),
        'norm_ffn1_post': gain(D_MODEL),
        'norm_mix_pre': gain(D_MODEL),
        'w_in': nrm((DEPTH, D_MODEL, D_IN), D_MODEL ** -0.5),
        'conv_w': nrm((DEPTH, CONV_WIDTH, D_CONV), CONV_WIDTH ** -0.5),
        'attn_sinks': nrm((DEPTH, N_HEADS), 0.5),
        'norm_attn_out': gain(D_ATTN),
        'norm_conv_out': gain(D_CONV),
        'w_out': nrm((DEPTH, D_MIX, D_MODEL), D_MIX ** -0.5),
        'norm_mix_post': gain(D_MODEL),
        'norm_ffn2_pre': gain(D_MODEL),
        'w_ffn2_gate_up': nrm((DEPTH, D_MODEL, 2 * D_FF), D_MODEL ** -0.5),
        'w_ffn2_down': nrm((DEPTH, D_FF, D_MODEL), D_FF ** -0.5),
        'norm_ffn2_post': gain(D_MODEL),
        'norm_ple_pre': gain(D_MODEL),
        'w_ple_gate': nrm((DEPTH, D_MODEL, D_MODEL), D_MODEL ** -0.5),
        'w_ple_proj': nrm((DEPTH, D_PLE, D_MODEL), D_PLE ** -0.5),
        'norm_ple_post': gain(D_MODEL),
    }


def reference(x_prompt, x_sample, cache_attn_k, cache_attn_v, cache_conv, p_prompt, p_sample,
              norm_ffn1_pre, w_ffn1_gate_up, w_ffn1_down, norm_ffn1_post,
              norm_mix_pre, w_in, conv_w, attn_sinks, norm_attn_out, norm_conv_out, w_out, norm_mix_post,
              norm_ffn2_pre, w_ffn2_gate_up, w_ffn2_down, norm_ffn2_post,
              norm_ple_pre, w_ple_gate, w_ple_proj, norm_ple_post):
    hp, hs = x_prompt, x_sample
    kp_list, vp_list, cp_list, ksm_list, vsm_list, csm_list = [], [], [], [], [], []
    for i in range(DEPTH):
        w = (norm_ffn1_pre[i], w_ffn1_gate_up[i], w_ffn1_down[i], norm_ffn1_post[i],
             norm_mix_pre[i], w_in[i], conv_w[i], attn_sinks[i], norm_attn_out[i], norm_conv_out[i], w_out[i],
             norm_mix_post[i], norm_ffn2_pre[i], w_ffn2_gate_up[i], w_ffn2_down[i], norm_ffn2_post[i],
             norm_ple_pre[i], w_ple_gate[i], w_ple_proj[i], norm_ple_post[i])
        conv_zero = jnp.zeros((hp.shape[0], CONV_WIDTH - 1, D_CONV), hp.dtype)
        hp, kp, vp, cp = encoder_layer(hp, p_prompt[i], window_attention_prompt, conv_zero, *w)
        attend_sample = lambda q, k, v, s, ck=cache_attn_k[i], cv=cache_attn_v[i]: window_attention_sample(q, k, v, s, ck, cv)
        hs, ksm, vsm, csm = encoder_layer(hs, p_sample[i], attend_sample, cache_conv[i], *w)
        kp_list.append(kp); vp_list.append(vp); cp_list.append(cp)
        ksm_list.append(ksm); vsm_list.append(vsm); csm_list.append(csm)
    new_k_prompt = jnp.stack(kp_list)
    new_v_prompt = jnp.stack(vp_list)
    new_conv_prompt = jnp.stack(cp_list)
    new_k_sample = jnp.stack(ksm_list)
    new_v_sample = jnp.stack(vsm_list)
    new_conv_sample = jnp.stack(csm_list)
    return (hp, hs, new_k_prompt, new_v_prompt, new_conv_prompt, new_k_sample, new_v_sample, new_conv_sample)
```

```cpp
#include <hip/hip_runtime.h>
#include <cstdio>
#include <cstdint>
namespace pg8 {
#define PG8_LAS __attribute__((address_space(3)))
typedef unsigned short bf16_t;
typedef short bf16x8 __attribute__((ext_vector_type(8)));
typedef float f32x4 __attribute__((ext_vector_type(4)));
typedef unsigned u32x4 __attribute__((ext_vector_type(4)));
constexpr int BM = 256, BK = 64, HALF = 128, HTB = HALF * BK * 2  , STAGE_BYTES = 8 * HTB, NXCD = 8, WGM = 8;

__host__ __device__ __forceinline__ int lds_byte(int r, int c) { const int st = (r >> 4) * 2 + (c >> 5), rr = r & 15, cc = c & 31, ob = rr * 64 + cc * 2; return st * 1024 + (ob ^ (((ob >> 9) & 1) << 5)); }
__host__ __device__ __forceinline__ void stage_rc(int b, int& R, int& C) { const int st = b / 1024, sb = b % 1024, swz = sb ^ (((sb >> 9) & 1) << 5); R = (st >> 1) * 16 + swz / 64; C = (st & 1) * 32 + (swz % 64) / 2; }
__host__ __device__ __forceinline__ int perm32(int rho) { const int n = rho >> 4, i = rho & 15; return 8 * (i >> 2) + 4 * n + (i & 3); }

struct Unit { int pm, pn; };
struct Gemm { const bf16_t* A; const bf16_t* Bt; int M, N, K; };

struct StaticOrder {
    int nM, nN, nwg, G, c;
    __host__ __device__ void init(int M, int N, int G_, int c_) { nM = M / BM; nN = N / BM; nwg = nM * nN; G = G_; c = c_; }
    __host__ __device__ bool next(int i, Unit& u) const {
        const long L = (long)i * G + c; if (L >= nwg) return false;
        int wgid = (int)L; { const int q = nwg / NXCD, r = nwg % NXCD, xcd = wgid % NXCD, off = wgid / NXCD; wgid = (xcd < r ? xcd * (q + 1) : r * (q + 1) + (xcd - r) * q) + off; }
        const int nig = WGM * nN, gid = wgid / nig, fm = gid * WGM, gsz = (nM - fm) < WGM ? (nM - fm) : WGM;
        u.pm = fm + ((wgid % nig) % gsz); u.pn = (wgid % nig) / gsz; return true;
    }
    __device__ __forceinline__ void a_ready(const Unit&) const {}
    __device__ __forceinline__ void done(const Unit&) const {}
};

typedef float f32x2_t __attribute__((ext_vector_type(2))); typedef __bf16 bf16x2_t __attribute__((ext_vector_type(2)));
__device__ __forceinline__ unsigned cvtpk(float lo, float hi) { f32x2_t v = {lo, hi}; bf16x2_t b = __builtin_convertvector(v, bf16x2_t); return __builtin_bit_cast(unsigned, b); }
__device__ __forceinline__ u32x4 pack8(const f32x4 a, const f32x4 b) { u32x4 w; w.x = cvtpk(a[0], a[1]); w.y = cvtpk(a[2], a[3]); w.z = cvtpk(b[0], b[1]); w.w = cvtpk(b[2], b[3]); return w; }
__device__ __forceinline__ float bf_lo(unsigned w) { return __uint_as_float(w << 16); }
__device__ __forceinline__ float bf_hi(unsigned w) { return __uint_as_float(w & 0xffff0000u); }
__device__ __forceinline__ float sigmoid_f(float x) { return __builtin_amdgcn_rcpf(1.0f + __builtin_amdgcn_exp2f(-1.4426950408889634f * x)); }

struct EpiGateUp {
    static constexpr bool PERM = true, AFTER_DRAIN = false;
    bf16_t* H; const float* rstd; int ldh;
    __device__ __forceinline__ void operator()(const f32x4 (&acc)[2][2][4][2], const Unit& u, int wr, int wc, int fr, int fq) const {
        const int row0 = u.pm * BM + wr * 64 + fr; const int col0 = u.pn * HALF + wc * 32 + 8 * fq;
#pragma unroll
        for (int ai = 0; ai < 2; ++ai)
#pragma unroll
            for (int m = 0; m < 4; ++m) { const int row = row0 + ai * HALF + m * 16; const float rs = rstd[row];
                f32x4 h[2];
#pragma unroll
                for (int n = 0; n < 2; ++n) { const f32x4 g = acc[ai][0][m][n] * rs, up = acc[ai][1][m][n] * rs;
#pragma unroll
                    for (int e = 0; e < 4; ++e) h[n][e] = g[e] * sigmoid_f(g[e]) * up[e]; }
                *(u32x4*)(H + (size_t)row * ldh + col0) = pack8(h[0], h[1]); }
    }
};

struct EpiPlain {
    static constexpr bool PERM = true, AFTER_DRAIN = false;
    bf16_t* O; int ldc;
    __device__ __forceinline__ void operator()(const f32x4 (&acc)[2][2][4][2], const Unit& u, int wr, int wc, int fr, int fq) const {
        const int row0 = u.pm * BM + wr * 64 + fr; const int col0 = u.pn * BM + wc * 32 + 8 * fq;
#pragma unroll
        for (int ai = 0; ai < 2; ++ai)
#pragma unroll
            for (int m = 0; m < 4; ++m) { bf16_t* rowp = O + (size_t)(row0 + ai * HALF + m * 16) * ldc + col0;
#pragma unroll
                for (int bj = 0; bj < 2; ++bj) *(u32x4*)(rowp + bj * HALF) = pack8(acc[ai][bj][m][0], acc[ai][bj][m][1]); }
    }
};

struct EpiPle {
    static constexpr bool PERM = true, AFTER_DRAIN = false;
    bf16_t* O; const bf16_t* P; const float* rstd; int ldc;
    __device__ __forceinline__ void operator()(const f32x4 (&acc)[2][2][4][2], const Unit& u, int wr, int wc, int fr, int fq) const {
        const int row0 = u.pm * BM + wr * 64 + fr; const int col0 = u.pn * BM + wc * 32 + 8 * fq;
#pragma unroll
        for (int ai = 0; ai < 2; ++ai)
#pragma unroll
            for (int m = 0; m < 4; ++m) { const int row = row0 + ai * HALF + m * 16; const float rs = rstd[row]; const size_t off = (size_t)row * ldc + col0;
#pragma unroll
                for (int bj = 0; bj < 2; ++bj) { const u32x4 pv = *(const u32x4*)(P + off + bj * HALF); f32x4 a = acc[ai][bj][m][0] * rs, b = acc[ai][bj][m][1] * rs;
                    a[0] = sigmoid_f(a[0]) * bf_lo(pv.x); a[1] = sigmoid_f(a[1]) * bf_hi(pv.x); a[2] = sigmoid_f(a[2]) * bf_lo(pv.y); a[3] = sigmoid_f(a[3]) * bf_hi(pv.y);
                    b[0] = sigmoid_f(b[0]) * bf_lo(pv.z); b[1] = sigmoid_f(b[1]) * bf_hi(pv.z); b[2] = sigmoid_f(b[2]) * bf_lo(pv.w); b[3] = sigmoid_f(b[3]) * bf_hi(pv.w);
                    *(u32x4*)(O + off + bj * HALF) = pack8(a, b); } }
    }
};

struct EpiWin {
    static constexpr bool PERM = true, AFTER_DRAIN = false;
    bf16_t *Zq, *Zk, *Zv, *Zb, *Zc; const float* rstd; float qs;
    float *nk_p, *nv_p, *nc_p, *nk_s, *nv_s, *nc_s;
    __device__ __forceinline__ void operator()(const f32x4 (&acc)[2][2][4][2], const Unit& u, int wr, int wc, int fr, int fq) const {
        const int row0 = u.pm * BM + wr * 64 + fr; const int cw = wc * 32 + 8 * fq;
        const int pn = u.pn;
#pragma unroll
        for (int ai = 0; ai < 2; ++ai)
#pragma unroll
            for (int m = 0; m < 4; ++m) { const int row = row0 + ai * HALF + m * 16; const float rs = rstd[row];
                if (pn < 2) {
                    const float s = rs * qs;
#pragma unroll
                    for (int bj = 0; bj < 2; ++bj) *(u32x4*)(Zq + (size_t)row * 512 + pn * 256 + bj * HALF + cw) = pack8(acc[ai][bj][m][0] * s, acc[ai][bj][m][1] * s);
                } else if (pn == 2) {
                    const f32x4 k0 = acc[ai][0][m][0] * rs, k1 = acc[ai][0][m][1] * rs, v0 = acc[ai][1][m][0] * rs, v1 = acc[ai][1][m][1] * rs;
                    *(u32x4*)(Zk + (size_t)row * 128 + cw) = pack8(k0, k1);
                    *(u32x4*)(Zv + (size_t)row * 128 + cw) = pack8(v0, v1);
                    float* ko = nullptr; float* vo = nullptr;
                    if (row < 16384) { const int t = row & 4095; if (t >= 3968) { const size_t o = ((size_t)(row >> 12) * 128 + (t - 3968)) * 128 + cw; ko = nk_p + o; vo = nv_p + o; } }
                    else { const int ms = row - 16384; const size_t o = ((size_t)(ms >> 5) * 128 + 96 + (ms & 31)) * 128 + cw; ko = nk_s + o; vo = nv_s + o; }
                    if (ko) { *(f32x4*)ko = k0; *(f32x4*)(ko + 4) = k1; *(f32x4*)vo = v0; *(f32x4*)(vo + 4) = v1; }
                } else if (pn < 5) {
#pragma unroll
                    for (int bj = 0; bj < 2; ++bj) *(u32x4*)(Zb + (size_t)row * 512 + (pn - 3) * 256 + bj * HALF + cw) = pack8(acc[ai][bj][m][0] * rs, acc[ai][bj][m][1] * rs);
                } else {
                    const float s2 = rs * rs; const int cc = (pn - 5) * HALF + cw;
                    const f32x4 c0 = acc[ai][0][m][0] * acc[ai][1][m][0] * s2, c1 = acc[ai][0][m][1] * acc[ai][1][m][1] * s2;
                    *(u32x4*)(Zc + (size_t)row * 512 + cc) = pack8(c0, c1);
                    float* co = nullptr;
                    if (row < 16384) { const int t = row & 4095; if (t >= 4094) co = nc_p + ((size_t)(row >> 12) * 2 + (t - 4094)) * 512 + cc; }
                    else { const int ms = row - 16384; const int t = ms & 31; if (t >= 30) co = nc_s + ((size_t)(ms >> 5) * 2 + (t - 30)) * 512 + cc; }
                    if (co) { *(f32x4*)co = c0; *(f32x4*)(co + 4) = c1; }
                } }
    }
};

template <class Epi, class Sched, bool ALIGN_EPI = false, bool SP2 = false>
__device__ __forceinline__ void gemm_phase(PG8_LAS unsigned char* lds, const Gemm g, const Sched& S, const Epi& E) {
    const int tid = threadIdx.x, wid = __builtin_amdgcn_readfirstlane(tid >> 6), lane = tid & 63, wr = wid >> 2, wc = wid & 3, fr = lane & 15, fq = lane >> 4;
    const int K = g.K, nt = K / BK;
    unsigned voffA[2], voffB[2];
#pragma unroll
    for (int i = 0; i < 2; ++i) { int R, C; stage_rc(tid * 16 + i * 8192, R, C); const int Rb = Epi::PERM ? ((R & ~31) + perm32(R & 31)) : R;
        voffA[i] = (unsigned)(R * K + C) * 2u; voffB[i] = (unsigned)(Rb * K + C) * 2u; }
    const size_t kstep = (size_t)(BK * 2);
    const size_t hstep = (size_t)HALF * K * 2;
    const size_t tstep = 2 * hstep;
    const unsigned ldsw = (unsigned)wid * 1024u;
    const int aoff = lds_byte(wr * 64 + fr, fq * 8), boff = lds_byte(wc * 32 + fr, fq * 8);
#define PG8_SA(b, h) (((b) * 2 + (h)) * HTB)
#define PG8_SB(b, h) ((4 + (b) * 2 + (h)) * HTB)
#define PG8_STAGE(bufoff, gbase, voff) do { _Pragma("unroll") for (int _i = 0; _i < 2; ++_i) \
        __builtin_amdgcn_global_load_lds((const unsigned*)((const char*)(gbase) + (voff)[_i]), (PG8_LAS unsigned*)(lds + (bufoff) + ldsw + _i * 8192), 16, 0, 0); } while (0)
#define PG8_LDA(dst, b, h) do { _Pragma("unroll") for (int m = 0; m < 4; ++m) _Pragma("unroll") for (int k = 0; k < 2; ++k) dst[m][k] = *(const PG8_LAS bf16x8*)(lds + PG8_SA(b, h) + aoff + m * 2048 + k * 1024); } while (0)
#define PG8_LDB(dst, b, h) do { _Pragma("unroll") for (int n = 0; n < 2; ++n) _Pragma("unroll") for (int k = 0; k < 2; ++k) dst[n][k] = *(const PG8_LAS bf16x8*)(lds + PG8_SB(b, h) + boff + n * 2048 + k * 1024); } while (0)
#define PG8_MMA(ai, bj, At, Bt) do { __builtin_amdgcn_s_setprio(1); _Pragma("unroll") for (int m = 0; m < 4; ++m) _Pragma("unroll") for (int n = 0; n < 2; ++n) _Pragma("unroll") for (int k = 0; k < 2; ++k) \
        acc[ai][bj][m][n] = __builtin_amdgcn_mfma_f32_16x16x32_bf16(Bt[n][k], At[m][k], acc[ai][bj][m][n], 0, 0, 0); __builtin_amdgcn_s_setprio(0); } while (0)
#define PG8_WAIT_V(n) asm volatile("s_waitcnt vmcnt(" #n ")" ::: "memory")
#define PG8_WAIT_L(n) asm volatile("s_waitcnt lgkmcnt(" #n ")" ::: "memory")
#define PG8_BAR __builtin_amdgcn_s_barrier()
#define PG8_SCHED __builtin_amdgcn_sched_barrier(0)
    Unit cur, nxt; int ui = 0;
    if (!S.next(0, cur)) return;
    f32x4 acc[2][2][4][2];
#pragma unroll
    for (int a = 0; a < 2; ++a)
#pragma unroll
        for (int b = 0; b < 2; ++b)
#pragma unroll
            for (int m = 0; m < 4; ++m)
#pragma unroll
                for (int n = 0; n < 2; ++n) acc[a][b][m][n] = (f32x4){0.f, 0.f, 0.f, 0.f};
    bf16x8 At[4][2], B0[2][2], B1[2][2];
    const char* cA = (const char*)g.A + (size_t)cur.pm * tstep; const char* cB = (const char*)g.Bt + (size_t)cur.pn * tstep;
    S.a_ready(cur);
    if constexpr (SP2) {
        PG8_STAGE(PG8_SB(0, 0), cB, voffB); PG8_STAGE(PG8_SB(0, 1), cB + hstep, voffB); PG8_STAGE(PG8_SA(0, 0), cA, voffA); PG8_STAGE(PG8_SA(0, 1), cA + hstep, voffA);
        if (wr == 1) PG8_BAR;
        PG8_WAIT_V(2); PG8_BAR;
        PG8_STAGE(PG8_SB(1, 0), cB + kstep, voffB); PG8_STAGE(PG8_SA(1, 0), cA + kstep, voffA); PG8_STAGE(PG8_SB(1, 1), cB + hstep + kstep, voffB);
        PG8_WAIT_V(6); PG8_BAR;
    } else {
        PG8_STAGE(PG8_SB(0, 0), cB, voffB); PG8_STAGE(PG8_SA(0, 0), cA, voffA); PG8_STAGE(PG8_SB(0, 1), cB + hstep, voffB); PG8_STAGE(PG8_SA(0, 1), cA + hstep, voffA);
        if (wr == 1) PG8_BAR;
        PG8_WAIT_V(4); PG8_BAR;
        PG8_STAGE(PG8_SB(1, 0), cB + kstep, voffB); PG8_STAGE(PG8_SA(1, 0), cA + kstep, voffA); PG8_STAGE(PG8_SB(1, 1), cB + hstep + kstep, voffB);
        PG8_WAIT_V(6); PG8_BAR;
    }
    for (;;) {
        const bool has_next = S.next(ui + 1, nxt);
        const char* nA = has_next ? (const char*)g.A + (size_t)nxt.pm * tstep : cA; const char* nB = has_next ? (const char*)g.Bt + (size_t)nxt.pn * tstep : cB;
        for (int t = 0; t < nt; t += 2) {
            const bool last = (t == nt - 2);
            const char* a1 = cA + (size_t)(t + 1) * kstep;
            const char* a2 = last ? nA : cA + (size_t)(t + 2) * kstep; const char* b2 = last ? nB : cB + (size_t)(t + 2) * kstep;
            const char* a3 = a2 + kstep; const char* b3 = b2 + kstep;
            if (last && has_next) S.a_ready(nxt);
            if constexpr (SP2) {
            PG8_LDB(B0, 0, 0); PG8_LDB(B1, 0, 1); PG8_SCHED; PG8_LDA(At, 0, 0); PG8_STAGE(PG8_SA(1, 1), a1 + hstep, voffA);
            PG8_WAIT_V(8); PG8_WAIT_L(0); PG8_BAR; PG8_MMA(0, 0, At, B0); PG8_MMA(0, 1, At, B1); PG8_BAR; PG8_SCHED;
            PG8_LDA(At, 0, 1); PG8_STAGE(PG8_SB(0, 0), b2, voffB); PG8_STAGE(PG8_SB(0, 1), b2 + hstep, voffB); PG8_STAGE(PG8_SA(0, 0), a2, voffA);
            PG8_WAIT_V(8); PG8_WAIT_L(0); PG8_BAR; PG8_MMA(1, 0, At, B0); PG8_MMA(1, 1, At, B1); PG8_BAR; PG8_SCHED;
            PG8_LDB(B0, 1, 0); PG8_LDB(B1, 1, 1); PG8_SCHED; PG8_LDA(At, 1, 0); PG8_STAGE(PG8_SA(0, 1), a2 + hstep, voffA);
            PG8_WAIT_V(8); PG8_WAIT_L(0); PG8_BAR; PG8_MMA(0, 0, At, B0); PG8_MMA(0, 1, At, B1); PG8_BAR; PG8_SCHED;
            PG8_LDA(At, 1, 1); PG8_STAGE(PG8_SB(1, 0), b3, voffB); PG8_STAGE(PG8_SB(1, 1), b3 + hstep, voffB); PG8_STAGE(PG8_SA(1, 0), a3, voffA);
            PG8_WAIT_V(8); PG8_WAIT_L(0); PG8_BAR; PG8_MMA(1, 0, At, B0); PG8_MMA(1, 1, At, B1); PG8_BAR; PG8_SCHED;
            } else {
            PG8_LDB(B0, 0, 0); PG8_SCHED; PG8_LDA(At, 0, 0); PG8_STAGE(PG8_SA(1, 1), a1 + hstep, voffA);
            PG8_WAIT_L(8); PG8_BAR; PG8_WAIT_L(0); PG8_MMA(0, 0, At, B0); PG8_BAR; PG8_SCHED;
            PG8_LDB(B1, 0, 1); PG8_STAGE(PG8_SB(0, 0), b2, voffB);
            PG8_BAR; PG8_WAIT_L(0); PG8_MMA(0, 1, At, B1); PG8_BAR;
            PG8_LDA(At, 0, 1); PG8_STAGE(PG8_SA(0, 0), a2, voffA);
            PG8_BAR; PG8_WAIT_L(0); PG8_MMA(1, 0, At, B0); PG8_BAR; PG8_SCHED;
            PG8_STAGE(PG8_SB(0, 1), b2 + hstep, voffB);
            PG8_WAIT_V(6); PG8_BAR; PG8_MMA(1, 1, At, B1); PG8_BAR;
            PG8_LDB(B0, 1, 0); PG8_SCHED; PG8_LDA(At, 1, 0); PG8_STAGE(PG8_SA(0, 1), a2 + hstep, voffA);
            PG8_WAIT_L(8); PG8_BAR; PG8_WAIT_L(0); PG8_MMA(0, 0, At, B0); PG8_BAR; PG8_SCHED;
            PG8_LDB(B1, 1, 1); PG8_STAGE(PG8_SB(1, 0), b3, voffB);
            PG8_BAR; PG8_WAIT_L(0); PG8_MMA(0, 1, At, B1); PG8_BAR;
            PG8_LDA(At, 1, 1); PG8_STAGE(PG8_SA(1, 0), a3, voffA);
            PG8_BAR; PG8_WAIT_L(0); PG8_MMA(1, 0, At, B0); PG8_BAR; PG8_SCHED;
            PG8_STAGE(PG8_SB(1, 1), b3 + hstep, voffB);
            PG8_WAIT_V(6); PG8_BAR; PG8_MMA(1, 1, At, B1); PG8_BAR;
            }
        }
        if constexpr (ALIGN_EPI) { if (wr == 0) PG8_BAR; }
        if constexpr (!Epi::AFTER_DRAIN) { E(acc, cur, wr, wc, fr, fq); S.done(cur); }
        if (!has_next) break;
#pragma unroll
        for (int a = 0; a < 2; ++a)
#pragma unroll
            for (int b = 0; b < 2; ++b)
#pragma unroll
                for (int m = 0; m < 4; ++m)
#pragma unroll
                    for (int n = 0; n < 2; ++n) acc[a][b][m][n] = (f32x4){0.f, 0.f, 0.f, 0.f};
        cur = nxt; cA = nA; cB = nB; ++ui;
        if constexpr (ALIGN_EPI) { if (wr == 1) PG8_BAR; }
    }
    PG8_WAIT_V(0);
    if constexpr (!ALIGN_EPI) { if (wr == 0) PG8_BAR; }
    PG8_BAR;
    if constexpr (Epi::AFTER_DRAIN) { E.fused(acc, cur, wr, wc, fr, fq, lds, wid, lane); S.done(cur); }
#undef PG8_SA
#undef PG8_SB
#undef PG8_STAGE
#undef PG8_LDA
#undef PG8_LDB
#undef PG8_MMA
#undef PG8_WAIT_V
#undef PG8_WAIT_L
#undef PG8_BAR
#undef PG8_SCHED
}
}
#define PG8_SP2 true
#define PG8_ALIGN true
#define GAS __attribute__((address_space(1)))
#define LAS __attribute__((address_space(3)))
typedef unsigned short bf16;
typedef unsigned v4u __attribute__((ext_vector_type(4)));
typedef float f32x4 __attribute__((ext_vector_type(4)));
typedef short bf16x8 __attribute__((ext_vector_type(8)));
typedef GAS unsigned gu32;
typedef GAS unsigned long long gu64;
#define RLX_AGENT __ATOMIC_RELAXED, __HIP_MEMORY_SCOPE_AGENT
#define LDS_WAIT() asm volatile("s_waitcnt lgkmcnt(0)" ::: "memory")
#define VM_WAIT() asm volatile("s_waitcnt vmcnt(0)" ::: "memory")
__device__ __forceinline__ unsigned long long rt() { return __builtin_amdgcn_s_memrealtime(); }
__device__ __forceinline__ unsigned f2bf(float f) { unsigned u = __builtin_bit_cast(unsigned, f); return (u + 0x7fffu + ((u >> 16) & 1u)) >> 16; }
__device__ __forceinline__ unsigned pk2(float lo, float hi) { return f2bf(lo) | (f2bf(hi) << 16); }

#define XB_TMO      128
#define XB_XCNT(j)  (256  + 64 * (j))
#define XB_XSUB(j)  (1280 + 64 * (j))
#define XB_XGEN(j)  (2304 + 64 * (j))
#define XB_TOP      3328
#define XB_TOPGEN   3392
#define XCD_BAR_WORDS 3456
#define XB_SPIN_CAP (1u << 18)

__device__ __forceinline__ unsigned xb_ld(unsigned* p)              { return __hip_atomic_load(p, __ATOMIC_RELAXED, __HIP_MEMORY_SCOPE_AGENT); }
__device__ __forceinline__ unsigned xb_add(unsigned* p, unsigned v) { return __hip_atomic_fetch_add(p, v, __ATOMIC_RELAXED, __HIP_MEMORY_SCOPE_AGENT); }
__device__ __forceinline__ unsigned xb_xcc_id() { return (unsigned)__builtin_amdgcn_s_getreg((3 << 11) | 20) & 0xFu; }
#define XB_SPIN(cond, bar) do { unsigned _sp = 0; while (cond) { __builtin_amdgcn_s_sleep(1); \
    if ((++_sp & 255u) == 0u) { if (xb_ld(&(bar)[XB_TMO])) break; if (_sp > XB_SPIN_CAP) { atomicAdd(&(bar)[XB_TMO], 1u); break; } } } } while (0)

struct XcdBarrier {
    unsigned* bar; unsigned x;
    volatile LAS unsigned* st;
};

__device__ __forceinline__ XcdBarrier xcd_barrier_post(unsigned* bar, volatile LAS unsigned* st) {
    XcdBarrier b; b.bar = bar; b.x = xb_xcc_id(); b.st = st;
    if (threadIdx.x == 0) (void)xb_add(&bar[XB_XCNT(b.x)], 1u);
    return b;
}
__device__ __forceinline__ void xcd_barrier_complete(unsigned* bar, unsigned x, unsigned& nloc, unsigned& nx) {
    const unsigned G = gridDim.x * gridDim.y * gridDim.z;
    unsigned sum, cnt, mine, sp = 0u;
    for (;;) {
        sum = 0u; cnt = 0u; mine = 0u;
#pragma unroll
        for (unsigned j = 0; j < 16; ++j) { const unsigned c = xb_ld(&bar[XB_XCNT(j)]); sum += c; cnt += (c > 0u) ? 1u : 0u; mine = (j == x) ? c : mine; }
        if (sum == G) break;
        __builtin_amdgcn_s_sleep(1);
        if ((++sp & 255u) == 0u) { if (xb_ld(&bar[XB_TMO])) break; if (sp > XB_SPIN_CAP) { atomicAdd(&bar[XB_TMO], 1u); break; } }
    }
    nloc = mine > 0u ? mine : 1u; nx = cnt > 0u ? cnt : 1u;
}

__device__ __forceinline__ void xcd_barrier(const XcdBarrier& b) {
    asm volatile("s_waitcnt vmcnt(0)" ::: "memory");
    __syncthreads();
    if (threadIdx.x == 0) {
        unsigned* bar = b.bar;
        __builtin_amdgcn_s_waitcnt(0);
        unsigned nloc = b.st[0], nx = b.st[1];
        if (nloc == 0u) { xcd_barrier_complete(bar, b.x, nloc, nx); b.st[0] = nloc; b.st[1] = nx; }
        const unsigned old = xb_add(&bar[XB_XSUB(b.x)], 1u);
        const unsigned gen = old / nloc;
        if (old + 1u == (gen + 1u) * nloc) {
            __builtin_amdgcn_fence(__ATOMIC_RELEASE, "agent");
            asm volatile("s_waitcnt vmcnt(0)" ::: "memory");
            const unsigned og = xb_add(&bar[XB_TOP], 1u);
            const unsigned tg = og / nx;
            if (og + 1u == (tg + 1u) * nx) xb_add(&bar[XB_TOPGEN], 1u);
            else XB_SPIN(xb_ld(&bar[XB_TOPGEN]) == tg, bar);
            __builtin_amdgcn_fence(__ATOMIC_ACQUIRE, "agent");
            xb_add(&bar[XB_XGEN(b.x)], 1u);
            asm volatile("s_waitcnt vmcnt(0)" ::: "memory");
        } else {
            XB_SPIN(xb_ld(&bar[XB_XGEN(b.x)]) == gen, bar);
            __builtin_amdgcn_fence(__ATOMIC_ACQUIRE, "agent");
            asm volatile("s_waitcnt vmcnt(0)" ::: "memory");
        }
    }
    __syncthreads();
}
typedef float f32x2v __attribute__((ext_vector_type(2)));
constexpr int NWAVES = 8;
constexpr int D = 1024, FF = 2816, DPLE = 256, MP = 16384, MS = 512, M = MP + MS, SEQ = 4096, DSEQ = 32, NBP = 4, NBS = 16;
constexpr int NGU = 2 * FF  , NIN = 2304;
constexpr float RMS_EPS = 1e-6f;
constexpr float QSCALE = 0.125f * 1.4426950408889634f;
constexpr size_t O_Y = 0, O_KP = (size_t)M * D, O_VP = O_KP + 65536, O_CP = O_VP + 65536, O_KS = O_CP + 4096, O_VS = O_KS + 262144, O_CS = O_VS + 262144, O_END = O_CS + 16384;
constexpr size_t MiB = 1u << 20;
constexpr size_t WS_CTL = 0, CTL_ZERO_BYTES = 1 * MiB;
constexpr size_t WS_STAT = 1 * MiB;
constexpr size_t WS_WGU1 = 2 * MiB, WS_WD1 = WS_WGU1 + (size_t)NGU * D * 2, WS_WIN = WS_WD1 + (size_t)D * FF * 2, WS_WOUT = WS_WIN + (size_t)NIN * D * 2,
                 WS_WGU2 = WS_WOUT + (size_t)D * D * 2, WS_WD2 = WS_WGU2 + (size_t)NGU * D * 2, WS_WPG = WS_WD2 + (size_t)D * FF * 2, WS_WPP = WS_WPG + (size_t)D * D * 2,
                 WS_WEND = WS_WPP + (size_t)D * DPLE * 2;
static_assert(WS_WEND <= 46 * MiB, "weights fit");
constexpr size_t WS_XB = 46 * MiB;
constexpr size_t WS_H = 79 * MiB;
constexpr size_t WS_ZQ = WS_H, WS_ZK = WS_ZQ + (size_t)M * 512 * 2, WS_ZV = WS_ZK + (size_t)M * 128 * 2, WS_ZB = WS_ZV + (size_t)M * 128 * 2, WS_ZC = WS_ZB + (size_t)M * 512 * 2,
                 WS_MI = WS_ZC + (size_t)M * 512 * 2;
constexpr size_t WS_HEND = WS_H + (size_t)M * FF * 2;
static_assert(WS_MI + (size_t)M * D * 2 <= WS_HEND, "z + mi overlay fits in h");
constexpr size_t WS_P = WS_HEND;
constexpr size_t WS_PB = WS_P + (size_t)M * D * 2;
constexpr size_t WS_F = WS_PB + (size_t)M * DPLE * 2;
constexpr size_t WS_END = WS_F + (size_t)M * D * 2;
static_assert(WS_END <= 256 * MiB, "d_ws map");
constexpr int CW_TMO = 0, CW_CODE = 1, CW_BAR = 4096;

constexpr int RING_OFF = 0, RING_BYTES = 131072;
constexpr int LDSCTL_OFF = RING_BYTES, MISC_OFF = LDSCTL_OFF + 320;
constexpr int LDS_BYTES = 147456;

struct Frame {
    LAS unsigned char* lds;
    volatile LAS unsigned* MISC;
    gu32* ctl;
    int tid, lane, wave;
    int vcu, G;
};

__device__ __forceinline__ float wave_sum(float v) {
#pragma unroll
    for (int o = 1; o < 64; o <<= 1) v += __shfl_xor(v, o);
    return v;
}
__device__ __forceinline__ unsigned pkbf(float lo, float hi) { return pg8::cvtpk(lo, hi); }

__device__ __forceinline__ int wmap(int mode, int n0) {
    if (mode == 1) { const int t = n0 >> 8, bj = (n0 >> 7) & 1, cc = n0 & 127; return bj * FF + t * 128 + cc; }
    if (mode == 2) { if (n0 < 1280) return n0; const int r = n0 - 1280, t = r >> 8, bj = (r >> 7) & 1, cc = r & 127; return 1280 + bj * 512 + t * 128 + cc; }
    return n0;
}
__device__ __forceinline__ void transpose_item(const float* W, int K, int Nsrc, int Ndst, bf16* WT, int mode, const float* gain, const float* gain2, LAS float* scr, int item, int lane) {
    const int nblk = Ndst / 32, kb = item / nblk, nb = item % nblk, k0 = 64 * kb, n0 = 32 * nb; const int s0 = wmap(mode, n0);
#pragma unroll 8
    for (int i = 0; i < 32; ++i) { const int kk = 2 * i + (lane >> 5); const int k = k0 + kk;
        float g = 1.f; if (gain) g = (gain2 && k >= 512) ? gain2[k - 512] : gain[k];
        scr[kk * 33 + (lane & 31)] = W[(size_t)k * Nsrc + s0 + (lane & 31)] * g; }
    LDS_WAIT(); asm volatile("" ::: "memory");
    const int c = lane & 7;
#pragma unroll
    for (int j = 0; j < 4; ++j) { const int n = (lane >> 3) + 8 * j; const LAS float* s = scr + (8 * c) * 33 + n;
        v4u o; o.x = pkbf(s[0 * 33], s[1 * 33]); o.y = pkbf(s[2 * 33], s[3 * 33]); o.z = pkbf(s[4 * 33], s[5 * 33]); o.w = pkbf(s[6 * 33], s[7 * 33]);
        *(GAS v4u*)(WT + (size_t)(n0 + n) * K + k0 + 8 * c) = o; }
    LDS_WAIT(); asm volatile("" ::: "memory");
}

struct Ptrs {
    const float *x_p, *x_s, *ck, *cv, *cc, *p_p, *p_s;
    const float *g_f1pre, *w_gu1, *w_d1, *g_f1post, *g_mixpre, *w_in, *conv_w, *sinks, *g_ao, *g_co, *w_out, *g_mixpost, *g_f2pre, *w_gu2, *w_d2, *g_f2post, *g_plepre, *w_pg, *w_pp, *g_plepost;
    float* out; unsigned char* ws;
};

__device__ __forceinline__ const float* xrow_ptr(const Ptrs& P, int m) { return m < MP ? P.x_p + (size_t)m * D : P.x_s + (size_t)(m - MP) * D; }

__device__ __forceinline__ void p0_prologue(const Frame& F, const Ptrs& P) {
    LAS float* scr = (LAS float*)(F.lds + RING_OFF + F.wave * 16384);
    const int gw = F.vcu * NWAVES + F.wave, NGW = F.G * NWAVES;
    unsigned char* ws = P.ws;
    constexpr int I_GU = (D / 64) * (NGU / 32), I_D = (FF / 64) * (D / 32), I_IN = (D / 64) * (NIN / 32), I_SQ = (D / 64) * (D / 32), I_PP = (DPLE / 64) * (D / 32);
    constexpr int NITEMS = 2 * I_GU + 2 * I_D + I_IN + 2 * I_SQ + I_PP;
    for (int it = gw; it < NITEMS; it += NGW) {
        int r = it;
        if (r < I_GU) { transpose_item(P.w_gu1, D, NGU, NGU, (bf16*)(ws + WS_WGU1), 1, P.g_f1pre, nullptr, scr, r, F.lane); continue; } r -= I_GU;
        if (r < I_GU) { transpose_item(P.w_gu2, D, NGU, NGU, (bf16*)(ws + WS_WGU2), 1, P.g_f2pre, nullptr, scr, r, F.lane); continue; } r -= I_GU;
        if (r < I_D) { transpose_item(P.w_d1, FF, D, D, (bf16*)(ws + WS_WD1), 0, nullptr, nullptr, scr, r, F.lane); continue; } r -= I_D;
        if (r < I_D) { transpose_item(P.w_d2, FF, D, D, (bf16*)(ws + WS_WD2), 0, nullptr, nullptr, scr, r, F.lane); continue; } r -= I_D;
        if (r < I_IN) { transpose_item(P.w_in, D, NIN, NIN, (bf16*)(ws + WS_WIN), 2, P.g_mixpre, nullptr, scr, r, F.lane); continue; } r -= I_IN;
        if (r < I_SQ) { transpose_item(P.w_out, D, D, D, (bf16*)(ws + WS_WOUT), 0, P.g_ao, P.g_co, scr, r, F.lane); continue; } r -= I_SQ;
        if (r < I_SQ) { transpose_item(P.w_pg, D, D, D, (bf16*)(ws + WS_WPG), 0, P.g_plepre, nullptr, scr, r, F.lane); continue; } r -= I_SQ;
        transpose_item(P.w_pp, DPLE, D, D, (bf16*)(ws + WS_WPP), 0, nullptr, nullptr, scr, r, F.lane);
    }
    float* rstd0 = (float*)(ws + WS_STAT);
    bf16* XB = (bf16*)(ws + WS_XB); bf16* PB = (bf16*)(ws + WS_PB);
    for (int m = gw; m < M; m += NGW) {
        const GAS f32x4* xr = (const GAS f32x4*)xrow_ptr(P, m) + F.lane;
        f32x4 v[4]; float s = 0.f;
#pragma unroll
        for (int j = 0; j < 4; ++j) { v[j] = xr[64 * j]; s += (v[j].x * v[j].x + v[j].y * v[j].y) + (v[j].z * v[j].z + v[j].w * v[j].w); }
        s = wave_sum(s);
        if (F.lane == 0) rstd0[m] = 1.0f / sqrtf(s * (1.f / D) + RMS_EPS);
        GAS unsigned long long* o8 = (GAS unsigned long long*)(XB + (size_t)m * D) + F.lane;
#pragma unroll
        for (int j = 0; j < 4; ++j) o8[64 * j] = (unsigned long long)pkbf(v[j].x, v[j].y) | ((unsigned long long)pkbf(v[j].z, v[j].w) << 32);
        const float* pr = m < MP ? P.p_p + (size_t)m * DPLE : P.p_s + (size_t)(m - MP) * DPLE;
        const f32x4 pv = ((const GAS f32x4*)pr)[F.lane];
        ((GAS unsigned long long*)(PB + (size_t)m * DPLE))[F.lane] = (unsigned long long)pkbf(pv.x, pv.y) | ((unsigned long long)pkbf(pv.z, pv.w) << 32);
    }
    for (int i = gw; i < NBS * 96; i += NGW) { const int b = i / 96, r = i % 96;
        const size_t so = ((size_t)b * 128 + 32 + r) * 128, dq = ((size_t)b * 128 + r) * 128;
        const f32x2v kk = ((const GAS f32x2v*)(P.ck + so))[F.lane], vv = ((const GAS f32x2v*)(P.cv + so))[F.lane];
        ((GAS f32x2v*)(P.out + O_KS + dq))[F.lane] = kk; ((GAS f32x2v*)(P.out + O_VS + dq))[F.lane] = vv; }
}

template <bool FIRST, bool LAST>
__device__ __forceinline__ void row_pass(const Frame& F, const Ptrs& P, const float* gain, float coef, float* rstd_out) {
    const int gw = F.vcu * NWAVES + F.wave, NGW = F.G * NWAVES;
    const bf16* Fb = (const bf16*)(P.ws + WS_F); bf16* RB = (bf16*)(P.ws + WS_XB); float* R = P.out + O_Y;
    f32x4 gv[2][2];
#pragma unroll
    for (int j = 0; j < 2; ++j) { gv[j][0] = *(const f32x4*)(gain + 512 * j + 8 * F.lane); gv[j][1] = *(const f32x4*)(gain + 512 * j + 8 * F.lane + 4); }
    for (int m = gw; m < M; m += NGW) {
        const float* rb = FIRST ? xrow_ptr(P, m) : (R + (size_t)m * D);
        v4u fw[2]; f32x4 rv[2][2];
#pragma unroll
        for (int j = 0; j < 2; ++j) { fw[j] = *(const GAS v4u*)(Fb + (size_t)m * D + 512 * j + 8 * F.lane);
            rv[j][0] = *(const GAS f32x4*)(rb + 512 * j + 8 * F.lane); rv[j][1] = *(const GAS f32x4*)(rb + 512 * j + 8 * F.lane + 4); }
        f32x4 fv[2][2]; float s = 0.f;
#pragma unroll
        for (int j = 0; j < 2; ++j) { fv[j][0] = (f32x4){pg8::bf_lo(fw[j].x), pg8::bf_hi(fw[j].x), pg8::bf_lo(fw[j].y), pg8::bf_hi(fw[j].y)};
            fv[j][1] = (f32x4){pg8::bf_lo(fw[j].z), pg8::bf_hi(fw[j].z), pg8::bf_lo(fw[j].w), pg8::bf_hi(fw[j].w)};
#pragma unroll
            for (int h = 0; h < 2; ++h) s += (fv[j][h].x * fv[j][h].x + fv[j][h].y * fv[j][h].y) + (fv[j][h].z * fv[j][h].z + fv[j][h].w * fv[j][h].w); }
        s = wave_sum(s);
        const float sc = coef / sqrtf(s * (1.f / D) + RMS_EPS);
        float s2 = 0.f;
#pragma unroll
        for (int j = 0; j < 2; ++j) {
#pragma unroll
            for (int h = 0; h < 2; ++h) { const f32x4 o = rv[j][h] + fv[j][h] * gv[j][h] * sc; rv[j][h] = o; s2 += (o.x * o.x + o.y * o.y) + (o.z * o.z + o.w * o.w);
                *(GAS f32x4*)(R + (size_t)m * D + 512 * j + 8 * F.lane + 4 * h) = o; }
            if (!LAST) *(GAS v4u*)(RB + (size_t)m * D + 512 * j + 8 * F.lane) = pg8::pack8(rv[j][0], rv[j][1]); }
        if (!LAST) { s2 = wave_sum(s2); if (F.lane == 0) rstd_out[m] = 1.0f / sqrtf(s2 * (1.f / D) + RMS_EPS); }
    }
}
constexpr int KL_STRIDE = 144, KL_HEAD = 192 * KL_STRIDE, VT_STRIDE = 400, VT_HEAD = 64 * VT_STRIDE;
constexpr int LDS_KL = 0, LDS_VT = 2 * KL_HEAD, LDS_SSQ = LDS_VT + 2 * VT_HEAD, LDS_ATT_END = LDS_SSQ + 8 * 64 * 4;
static_assert(LDS_ATT_END <= RING_BYTES, "attention LDS fits");
constexpr int N_ATT_UNITS = NBP * (SEQ / 64) + NBS;

__device__ __forceinline__ void vt_scatter(LAS unsigned short* vt, const v4u vv) {
    vt[0 * (VT_STRIDE / 2)] = (unsigned short)(vv.x & 0xffffu); vt[1 * (VT_STRIDE / 2)] = (unsigned short)(vv.x >> 16);
    vt[2 * (VT_STRIDE / 2)] = (unsigned short)(vv.y & 0xffffu); vt[3 * (VT_STRIDE / 2)] = (unsigned short)(vv.y >> 16);
    vt[4 * (VT_STRIDE / 2)] = (unsigned short)(vv.z & 0xffffu); vt[5 * (VT_STRIDE / 2)] = (unsigned short)(vv.z >> 16);
    vt[6 * (VT_STRIDE / 2)] = (unsigned short)(vv.w & 0xffffu); vt[7 * (VT_STRIDE / 2)] = (unsigned short)(vv.w >> 16);
}

__device__ __forceinline__ void attn_phase(const Frame& F, const Ptrs& P) {
    const bf16* Zq = (const bf16*)(P.ws + WS_ZQ); const bf16* Zk = (const bf16*)(P.ws + WS_ZK); const bf16* Zv = (const bf16*)(P.ws + WS_ZV);
    const bf16* Zb = (const bf16*)(P.ws + WS_ZB); const bf16* Zc = (const bf16*)(P.ws + WS_ZC); bf16* MI = (bf16*)(P.ws + WS_MI);
    LAS unsigned char* lds = F.lds;
    const int tid = F.tid, lane = F.lane, h = F.wave, kvh = h >> 2, qi = lane & 15, g = lane >> 4;
    const float sink2 = P.sinks[h] * 1.4426950408889634f;
    LAS float* ssq = (LAS float*)(lds + LDS_SSQ);
    f32x4 cw[3][2];
#pragma unroll
    for (int j = 0; j < 3; ++j) { cw[j][0] = *(const f32x4*)(P.conv_w + j * 512 + 8 * lane); cw[j][1] = *(const f32x4*)(P.conv_w + j * 512 + 8 * lane + 4); }

    for (int u = F.vcu; u < N_ATT_UNITS; u += F.G) {
        int row0, nq, krow0, nk_new, koff, sb; bool sample;
        if (u < NBP * 64) { const int b = u >> 6, c = u & 63; const int kc0 = c >= 2 ? c - 2 : 0; row0 = b * SEQ + 64 * c; nq = 64; krow0 = b * SEQ + 64 * kc0; nk_new = 64 * (c - kc0 + 1); koff = 0; sample = false; sb = 0; }
        else { sb = u - NBP * 64; row0 = MP + DSEQ * sb; nq = DSEQ; krow0 = row0; nk_new = DSEQ; koff = 128; sample = true; }
        const int nkt = (koff + nk_new) >> 4, nqb = nq >> 4;
        __syncthreads();
        if (sample) {
            for (int idx = tid; idx < 128 * 16; idx += NWAVES * 64) { const int key = idx >> 4, ch = idx & 15, kh = ch >> 3, d0 = (ch & 7) * 8;
                const size_t so = ((size_t)sb * 128 + key) * 128 + ch * 8;
                const f32x4 a = *(const GAS f32x4*)(P.ck + so), b2 = *(const GAS f32x4*)(P.ck + so + 4), c2 = *(const GAS f32x4*)(P.cv + so), d2 = *(const GAS f32x4*)(P.cv + so + 4);
                *(LAS v4u*)(lds + LDS_KL + kh * KL_HEAD + key * KL_STRIDE + d0 * 2) = pg8::pack8(a, b2);
                vt_scatter((LAS unsigned short*)(lds + LDS_VT + kh * VT_HEAD + d0 * VT_STRIDE + key * 2), pg8::pack8(c2, d2)); }
        }
        for (int idx = tid; idx < nk_new * 16; idx += NWAVES * 64) { const int key = idx >> 4, ch = idx & 15, kh = ch >> 3, d0 = (ch & 7) * 8;
            const size_t so = (size_t)(krow0 + key) * 128 + ch * 8;
            const v4u kv = *(const GAS v4u*)(Zk + so), vv = *(const GAS v4u*)(Zv + so);
            *(LAS v4u*)(lds + LDS_KL + kh * KL_HEAD + (koff + key) * KL_STRIDE + d0 * 2) = kv;
            vt_scatter((LAS unsigned short*)(lds + LDS_VT + kh * VT_HEAD + d0 * VT_STRIDE + (koff + key) * 2), vv); }
        __syncthreads();
        f32x4 o[4][4];
#pragma unroll
        for (int qb = 0; qb < 4; ++qb)
#pragma unroll
            for (int dt = 0; dt < 4; ++dt) o[qb][dt] = (f32x4){0.f, 0.f, 0.f, 0.f};
#pragma unroll
        for (int qb = 0; qb < 4; ++qb) {
            if (qb < nqb) {
                const bf16* qp = Zq + (size_t)(row0 + 16 * qb + qi) * 512 + h * 64 + 8 * g;
                const bf16x8 qf0 = *(const GAS bf16x8*)(qp), qf1 = *(const GAS bf16x8*)(qp + 32);
                f32x4 st[12];
#pragma unroll
                for (int T = 0; T < 12; ++T) {
                    if (T < nkt) {
                        const LAS unsigned char* kp = lds + LDS_KL + kvh * KL_HEAD + (16 * T + qi) * KL_STRIDE + 16 * g;
                        const bf16x8 k0 = *(const LAS bf16x8*)kp, k1 = *(const LAS bf16x8*)(kp + 64);
                        f32x4 a = (f32x4){0.f, 0.f, 0.f, 0.f};
                        a = __builtin_amdgcn_mfma_f32_16x16x32_bf16(k0, qf0, a, 0, 0, 0);
                        a = __builtin_amdgcn_mfma_f32_16x16x32_bf16(k1, qf1, a, 0, 0, 0);
                        st[T] = a;
                    } else st[T] = (f32x4){-INFINITY, -INFINITY, -INFINITY, -INFINITY};
                }
                float mx = sink2;
#pragma unroll
                for (int T = 0; T < 12; ++T) mx = fmaxf(mx, fmaxf(fmaxf(st[T][0], st[T][1]), fmaxf(st[T][2], st[T][3])));
                mx = fmaxf(mx, __shfl_xor(mx, 16)); mx = fmaxf(mx, __shfl_xor(mx, 32));
                float sum = 0.f;
#pragma unroll
                for (int T = 0; T < 12; ++T)
#pragma unroll
                    for (int e = 0; e < 4; ++e) { const float ev = __builtin_amdgcn_exp2f(st[T][e] - mx); st[T][e] = ev; sum += ev; }
                sum += __shfl_xor(sum, 16); sum += __shfl_xor(sum, 32);
                const float inv = 1.0f / (sum + __builtin_amdgcn_exp2f(sink2 - mx));
#pragma unroll
                for (int T2 = 0; T2 < 6; ++T2) {
                    if (2 * T2 < nkt) {
                        v4u pw; pw.x = pkbf(st[2 * T2][0] * inv, st[2 * T2][1] * inv); pw.y = pkbf(st[2 * T2][2] * inv, st[2 * T2][3] * inv);
                        pw.z = pkbf(st[2 * T2 + 1][0] * inv, st[2 * T2 + 1][1] * inv); pw.w = pkbf(st[2 * T2 + 1][2] * inv, st[2 * T2 + 1][3] * inv);
                        const bf16x8 pf = __builtin_bit_cast(bf16x8, pw);
#pragma unroll
                        for (int dt = 0; dt < 4; ++dt) {
                            const LAS unsigned char* vp = lds + LDS_VT + kvh * VT_HEAD + (16 * dt + qi) * VT_STRIDE + (32 * T2 + 4 * g) * 2;
                            typedef unsigned u32x2v __attribute__((ext_vector_type(2)));
                            const u32x2v lo = *(const LAS u32x2v*)vp, hi = *(const LAS u32x2v*)(vp + 32);
                            v4u vw; vw.x = lo.x; vw.y = lo.y; vw.z = hi.x; vw.w = hi.y;
                            o[qb][dt] = __builtin_amdgcn_mfma_f32_16x16x32_bf16(__builtin_bit_cast(bf16x8, vw), pf, o[qb][dt], 0, 0, 0);
                        }
                    }
                }
                float s = 0.f;
#pragma unroll
                for (int dt = 0; dt < 4; ++dt) s += (o[qb][dt][0] * o[qb][dt][0] + o[qb][dt][1] * o[qb][dt][1]) + (o[qb][dt][2] * o[qb][dt][2] + o[qb][dt][3] * o[qb][dt][3]);
                s += __shfl_xor(s, 16); s += __shfl_xor(s, 32);
                if (g == 0) ssq[h * 64 + 16 * qb + qi] = s;
            }
        }
        __syncthreads();
#pragma unroll
        for (int qb = 0; qb < 4; ++qb) {
            if (qb < nqb) {
                float tot = 0.f;
#pragma unroll
                for (int hh = 0; hh < 8; ++hh) tot += ssq[hh * 64 + 16 * qb + qi];
                const float rs = 1.0f / sqrtf(tot * (1.f / 512.f) + RMS_EPS);
                bf16* mp = MI + (size_t)(row0 + 16 * qb + qi) * D + h * 64 + 4 * g;
#pragma unroll
                for (int dt = 0; dt < 4; ++dt) { const f32x4 v = o[qb][dt] * rs;
                    *(GAS unsigned long long*)(mp + 16 * dt) = (unsigned long long)pkbf(v[0], v[1]) | ((unsigned long long)pkbf(v[2], v[3]) << 32); }
            }
        }
        for (int r = F.wave; r < nq; r += NWAVES) {
            const int m = row0 + r; const int t = sample ? r : (m & (SEQ - 1));
            const v4u bgw = *(const GAS v4u*)(Zb + (size_t)m * 512 + 8 * lane), c0w = *(const GAS v4u*)(Zc + (size_t)m * 512 + 8 * lane);
            f32x4 p1[2], p2[2];
            if (t >= 1) { const v4u w = *(const GAS v4u*)(Zc + (size_t)(m - 1) * 512 + 8 * lane);
                p1[0] = (f32x4){pg8::bf_lo(w.x), pg8::bf_hi(w.x), pg8::bf_lo(w.y), pg8::bf_hi(w.y)}; p1[1] = (f32x4){pg8::bf_lo(w.z), pg8::bf_hi(w.z), pg8::bf_lo(w.w), pg8::bf_hi(w.w)}; }
            else if (sample) { const float* cp = P.cc + ((size_t)sb * 2 + 1) * 512 + 8 * lane; p1[0] = *(const GAS f32x4*)cp; p1[1] = *(const GAS f32x4*)(cp + 4); }
            else { p1[0] = (f32x4){0.f, 0.f, 0.f, 0.f}; p1[1] = p1[0]; }
            if (t >= 2) { const v4u w = *(const GAS v4u*)(Zc + (size_t)(m - 2) * 512 + 8 * lane);
                p2[0] = (f32x4){pg8::bf_lo(w.x), pg8::bf_hi(w.x), pg8::bf_lo(w.y), pg8::bf_hi(w.y)}; p2[1] = (f32x4){pg8::bf_lo(w.z), pg8::bf_hi(w.z), pg8::bf_lo(w.w), pg8::bf_hi(w.w)}; }
            else if (sample) { const float* cp = P.cc + ((size_t)sb * 2 + t) * 512 + 8 * lane; p2[0] = *(const GAS f32x4*)cp; p2[1] = *(const GAS f32x4*)(cp + 4); }
            else { p2[0] = (f32x4){0.f, 0.f, 0.f, 0.f}; p2[1] = p2[0]; }
            f32x4 cur[2], bg[2];
            cur[0] = (f32x4){pg8::bf_lo(c0w.x), pg8::bf_hi(c0w.x), pg8::bf_lo(c0w.y), pg8::bf_hi(c0w.y)}; cur[1] = (f32x4){pg8::bf_lo(c0w.z), pg8::bf_hi(c0w.z), pg8::bf_lo(c0w.w), pg8::bf_hi(c0w.w)};
            bg[0] = (f32x4){pg8::bf_lo(bgw.x), pg8::bf_hi(bgw.x), pg8::bf_lo(bgw.y), pg8::bf_hi(bgw.y)}; bg[1] = (f32x4){pg8::bf_lo(bgw.z), pg8::bf_hi(bgw.z), pg8::bf_lo(bgw.w), pg8::bf_hi(bgw.w)};
            f32x4 y[2]; float s = 0.f;
#pragma unroll
            for (int k = 0; k < 2; ++k) { y[k] = bg[k] * (cw[0][k] * p2[k] + cw[1][k] * p1[k] + cw[2][k] * cur[k]); s += (y[k].x * y[k].x + y[k].y * y[k].y) + (y[k].z * y[k].z + y[k].w * y[k].w); }
            s = wave_sum(s);
            const float rs = 1.0f / sqrtf(s * (1.f / 512.f) + RMS_EPS);
            *(GAS v4u*)(MI + (size_t)m * D + 512 + 8 * lane) = pg8::pack8(y[0] * rs, y[1] * rs);
        }
    }
}
struct Args { const float* in[27]; float* out; unsigned char* ws; };
__global__ void __launch_bounds__(NWAVES * 64, 2) fwd_megakernel(Args args) {
    extern __shared__ __attribute__((aligned(16))) unsigned char lds[];
    Frame F;
    F.lds = (LAS unsigned char*)lds;
    F.MISC = (volatile LAS unsigned*)(F.lds + MISC_OFF);
    F.tid = threadIdx.x; F.lane = F.tid & 63; F.wave = __builtin_amdgcn_readfirstlane(F.tid >> 6);
    F.G = gridDim.x; { const int bx = blockIdx.x; F.vcu = (F.G % 8 == 0) ? (bx % 8) * (F.G / 8) + bx / 8 : bx; }
    unsigned char* ws = args.ws;
    F.ctl = (gu32*)(ws + WS_CTL);
    Ptrs P;
    P.x_p = args.in[0]; P.x_s = args.in[1]; P.ck = args.in[2]; P.cv = args.in[3]; P.cc = args.in[4]; P.p_p = args.in[5]; P.p_s = args.in[6];
    P.g_f1pre = args.in[7]; P.w_gu1 = args.in[8]; P.w_d1 = args.in[9]; P.g_f1post = args.in[10]; P.g_mixpre = args.in[11]; P.w_in = args.in[12]; P.conv_w = args.in[13]; P.sinks = args.in[14];
    P.g_ao = args.in[15]; P.g_co = args.in[16]; P.w_out = args.in[17]; P.g_mixpost = args.in[18]; P.g_f2pre = args.in[19]; P.w_gu2 = args.in[20]; P.w_d2 = args.in[21]; P.g_f2post = args.in[22];
    P.g_plepre = args.in[23]; P.w_pg = args.in[24]; P.w_pp = args.in[25]; P.g_plepost = args.in[26]; P.out = args.out; P.ws = ws;
    for (int u = F.tid; u < (LDS_BYTES - LDSCTL_OFF) / 4; u += NWAVES * 64) ((LAS unsigned*)(F.lds + LDSCTL_OFF))[u] = 0u;
    __syncthreads();
    XcdBarrier bar = xcd_barrier_post((unsigned*)(F.ctl + CW_BAR), F.MISC + 8);

    float* rstd0 = (float*)(ws + WS_STAT); float* rstd1 = rstd0 + M; float* rstd2 = rstd1 + M; float* rstd3 = rstd2 + M;
    pg8::bf16_t* XB = (pg8::bf16_t*)(ws + WS_XB); pg8::bf16_t* Hb = (pg8::bf16_t*)(ws + WS_H); pg8::bf16_t* Fb = (pg8::bf16_t*)(ws + WS_F);
    pg8::bf16_t* Pb = (pg8::bf16_t*)(ws + WS_P); pg8::bf16_t* PB = (pg8::bf16_t*)(ws + WS_PB); pg8::bf16_t* MI = (pg8::bf16_t*)(ws + WS_MI);
    const int bx = (int)blockIdx.x;
#define GEMM_PHASE(EPI, Aptr, Bptr, N_, K_, ...) do { pg8::Gemm g_{Aptr, (const pg8::bf16_t*)(Bptr), M, N_, K_}; pg8::StaticOrder S_; S_.init(M, N_, F.G, bx); \
        pg8::EPI E_{__VA_ARGS__}; pg8::gemm_phase<pg8::EPI, pg8::StaticOrder, true, true>(F.lds + RING_OFF, g_, S_, E_); } while (0)

    p0_prologue(F, P);
    xcd_barrier(bar);
    GEMM_PHASE(EpiGateUp, XB, ws + WS_WGU1, NGU, D, Hb, rstd0, FF);
    GEMM_PHASE(EpiPlain, PB, ws + WS_WPP, D, DPLE, Pb, D);
    xcd_barrier(bar);
    GEMM_PHASE(EpiPlain, Hb, ws + WS_WD1, D, FF, Fb, D);
    xcd_barrier(bar);
    row_pass<true, false>(F, P, P.g_f1post, 0.5f, rstd1);
    xcd_barrier(bar);
    GEMM_PHASE(EpiWin, XB, ws + WS_WIN, NIN, D, (pg8::bf16_t*)(ws + WS_ZQ), (pg8::bf16_t*)(ws + WS_ZK), (pg8::bf16_t*)(ws + WS_ZV), (pg8::bf16_t*)(ws + WS_ZB), (pg8::bf16_t*)(ws + WS_ZC), rstd1, QSCALE,
               P.out + O_KP, P.out + O_VP, P.out + O_CP, P.out + O_KS, P.out + O_VS, P.out + O_CS);
    xcd_barrier(bar);
    attn_phase(F, P);
    xcd_barrier(bar);
    GEMM_PHASE(EpiPlain, MI, ws + WS_WOUT, D, D, Fb, D);
    xcd_barrier(bar);
    row_pass<false, false>(F, P, P.g_mixpost, 1.0f, rstd2);
    xcd_barrier(bar);
    GEMM_PHASE(EpiGateUp, XB, ws + WS_WGU2, NGU, D, Hb, rstd2, FF);
    xcd_barrier(bar);
    GEMM_PHASE(EpiPlain, Hb, ws + WS_WD2, D, FF, Fb, D);
    xcd_barrier(bar);
    row_pass<false, false>(F, P, P.g_f2post, 0.5f, rstd3);
    xcd_barrier(bar);
    GEMM_PHASE(EpiPle, XB, ws + WS_WPG, D, D, Fb, Pb, rstd3, D);
    xcd_barrier(bar);
    row_pass<false, true>(F, P, P.g_plepost, 1.0f, nullptr);
#undef GEMM_PHASE
}

extern "C" void kernel_launch(void* const* d_in, const int* in_sizes, int n_in, void* d_out, int out_size, void* d_ws, size_t ws_size, hipStream_t stream) {
    static int grid = 0;
    if (grid == 0) {
        if (n_in != 27 || in_sizes[0] != MP * D || out_size != (int)O_END || ws_size < WS_END) { fprintf(stderr, "kernel_launch: unexpected shapes: n_in %d in0 %d out %d ws %zu\n", n_in, n_in > 0 ? in_sizes[0] : -1, out_size, ws_size); grid = -1; return; }
        int dev = 0, cus = 0, per_cu = 0;
        if (hipGetDevice(&dev) != hipSuccess || hipDeviceGetAttribute(&cus, hipDeviceAttributeMultiprocessorCount, dev) != hipSuccess) { grid = -1; return; }
        if (hipFuncSetAttribute((const void*)fwd_megakernel, hipFuncAttributeMaxDynamicSharedMemorySize, LDS_BYTES) != hipSuccess) { fprintf(stderr, "kernel_launch: hipFuncSetAttribute failed\n"); grid = -1; return; }
        if (hipOccupancyMaxActiveBlocksPerMultiprocessor(&per_cu, (const void*)fwd_megakernel, NWAVES * 64, LDS_BYTES) != hipSuccess || per_cu < 1) { fprintf(stderr, "kernel_launch: occupancy query says %d\n", per_cu); per_cu = 1; }
        (void)hipGetLastError();
        grid = cus;
    }
    if (grid < 0) return;
    if (hipMemsetAsync((char*)d_ws + WS_CTL, 0, CTL_ZERO_BYTES, stream) != hipSuccess) return;
    Args a{};
    for (int i = 0; i < 27; ++i) a.in[i] = (const float*)d_in[i];
    a.out = (float*)d_out; a.ws = (unsigned char*)d_ws;
    hipLaunchKernelGGL(fwd_megakernel, dim3(grid), dim3(NWAVES * 64), LDS_BYTES, stream, a);
}
```
